# Optimizing an MI355X kernel written in HIP

```python
import jax, jax.numpy as jnp
from jax import lax
import numpy as np

D_MODEL = 1024
BATCH = 8
SEQ = 4096
DEPTH = 1

D_MIX = D_MODEL
D_A = D_MIX // 2
D_B = D_MIX - D_A
N_HEADS_A = 4
HEAD_DIM_A = D_A // N_HEADS_A
CHUNK = 128
POOL_WINDOWS = (2, 4, 8, 16)
N_POOL_GROUPS = len(POOL_WINDOWS)
POOL_GROUP_DIM = D_B // N_POOL_GROUPS
D_FF = 4 * D_MODEL
N_MOD = 6
EPS = 1e-6

kernel_name = "hybrid_gmlp_pool_sqrelu_block"


def rms_norm(x, g):
    xf = x.astype(jnp.float32)
    y = xf * lax.rsqrt(jnp.mean(xf * xf, axis=-1, keepdims=True) + EPS)
    return (y * g.astype(jnp.float32)).astype(x.dtype)


def layer_norm(x, g, b):
    xf = x.astype(jnp.float32)
    mu = jnp.mean(xf, axis=-1, keepdims=True)
    var = jnp.mean(jnp.square(xf - mu), axis=-1, keepdims=True)
    y = (xf - mu) * lax.rsqrt(var + EPS)
    return (y * g.astype(jnp.float32) + b.astype(jnp.float32)).astype(x.dtype)


def spatial_gating(z_a, w_spatial, b_spatial, ln_v_gain, ln_v_bias):
    b, s, _ = z_a.shape
    z_a = jax.nn.gelu(z_a)
    u, v = z_a[..., :D_A], z_a[..., D_A:]
    v = layer_norm(v, ln_v_gain, ln_v_bias)
    v = v.reshape(b, s // CHUNK, CHUNK, N_HEADS_A, HEAD_DIM_A)
    mask = jnp.tril(jnp.ones((CHUNK, CHUNK), dtype=w_spatial.dtype))
    w_causal = w_spatial * mask[None]
    mixed = jnp.einsum("hts,bnshd->bnthd", w_causal, v)
    mixed = mixed + b_spatial.T[:, :, None]
    return u * mixed.reshape(b, s, D_A)


def multiscale_pool(z_b, w_pool, b_pool, pool_scale):
    b, s, _ = z_b.shape
    zg = z_b.reshape(b, s, N_POOL_GROUPS, POOL_GROUP_DIM)
    zf = zg.astype(jnp.float32)
    cs = jnp.concatenate(
        [jnp.zeros((b, 1, N_POOL_GROUPS, POOL_GROUP_DIM), jnp.float32), jnp.cumsum(zf, axis=1)],
        axis=1)
    pos = jnp.arange(s, dtype=jnp.float32)
    pooled = []
    for g, w in enumerate(POOL_WINDOWS):
        csg = cs[:, :, g]
        lower = jnp.concatenate(
            [jnp.zeros((b, w - 1, POOL_GROUP_DIM), jnp.float32), csg[:, : s + 1 - w]], axis=1)
        count = jnp.minimum(pos + 1.0, float(w))[None, :, None]
        pooled.append((csg[:, 1:] - lower) / count)
    pooled = jnp.stack(pooled, axis=2)
    diff = (pooled - zf).astype(z_b.dtype)
    y = jnp.einsum("bsgc,gcd->bsgd", diff, w_pool) + b_pool
    return y.reshape(b, s, D_B) * pool_scale


def setup_inputs(seed: int = 0) -> dict:
    key = jax.random.key(seed)
    ks = jax.random.split(key, 20)
    f32 = jnp.float32
    nrm = lambda k, shape, scale: jax.random.normal(k, shape, f32) * scale
    return {
        "x": nrm(ks[0], (BATCH, SEQ, D_MODEL), 1.0),
        "c": nrm(ks[1], (BATCH, D_MODEL), 1.0),
        "w_ada": nrm(ks[2], (D_MODEL, N_MOD * D_MODEL), 0.5 * D_MODEL ** -0.5),
        "b_ada": nrm(ks[3], (N_MOD * D_MODEL,), 0.01),
        "norm1_pre": 1.0 + nrm(ks[4], (D_MODEL,), 0.02),
        "norm1_post": 1.0 + nrm(ks[5], (D_MODEL,), 0.02),
        "w_in": nrm(ks[6], (D_MODEL, 2 * D_A + D_B), D_MODEL ** -0.5),
        "w_spatial": nrm(ks[7], (N_HEADS_A, CHUNK, CHUNK), 0.5 * CHUNK ** -0.5),
        "b_spatial": 1.0 + nrm(ks[8], (N_HEADS_A, CHUNK), 0.02),
        "ln_v_gain": 1.0 + nrm(ks[9], (D_A,), 0.02),
        "ln_v_bias": nrm(ks[10], (D_A,), 0.02),
        "w_pool": nrm(ks[11], (N_POOL_GROUPS, POOL_GROUP_DIM, POOL_GROUP_DIM), POOL_GROUP_DIM ** -0.5),
        "b_pool": nrm(ks[12], (N_POOL_GROUPS, POOL_GROUP_DIM), 0.02),
        "pool_scale": 1.0 + nrm(ks[13], (D_B,), 0.02),
        "w_out": nrm(ks[14], (D_MIX, D_MODEL), D_MIX ** -0.5),
        "norm2_pre": 1.0 + nrm(ks[15], (D_MODEL,), 0.02),
        "norm2_post": 1.0 + nrm(ks[16], (D_MODEL,), 0.02),
        "w_fc1": nrm(ks[17], (DEPTH, D_MODEL, D_FF), D_MODEL ** -0.5)[0],
        "w_fc2": nrm(ks[18], (D_FF, D_MODEL), D_FF ** -0.5),
    }


def reference(x, c, w_ada, b_ada, norm1_pre, norm1_post, w_in, w_spatial, b_spatial,
              ln_v_gain, ln_v_bias, w_pool, b_pool, pool_scale, w_out,
              norm2_pre, norm2_post, w_fc1, w_fc2):
    mod = jax.nn.silu(c) @ w_ada + b_ada
    shift1, scale1, gate1, shift2, scale2, gate2 = [
        m[:, None, :] for m in jnp.split(mod, N_MOD, axis=-1)]

    for _ in range(DEPTH):
        h = rms_norm(x, norm1_pre) * (1.0 + scale1) + shift1
        z = h @ w_in
        y_a = spatial_gating(z[..., : 2 * D_A], w_spatial, b_spatial, ln_v_gain, ln_v_bias)
        y_b = multiscale_pool(z[..., 2 * D_A:], w_pool, b_pool, pool_scale)
        mix = jnp.concatenate([y_a, y_b], axis=-1) @ w_out
        x = x + gate1 * rms_norm(mix, norm1_post)

        h = rms_norm(x, norm2_pre) * (1.0 + scale2) + shift2
        f = jnp.square(jax.nn.relu(h @ w_fc1)) @ w_fc2
        x = x + gate2 * rms_norm(f, norm2_post)
    return x
```

```cpp
#include <hip/hip_runtime.h>
#include <hip/hip_cooperative_groups.h>
#include <cstdio>
#include <cstdint>
namespace cg = cooperative_groups;
namespace pg8 {
#define PG8_LAS __attribute__((address_space(3)))
typedef unsigned short bf16_t;
typedef short bf16x8 __attribute__((ext_vector_type(8)));
typedef float f32x4 __attribute__((ext_vector_type(4)));
typedef unsigned u32x4 __attribute__((ext_vector_type(4)));
constexpr int BM = 256, BK = 64, HALF = 128, HTB = HALF * BK * 2  , STAGE_BYTES = 8 * HTB, NXCD = 8, WGM = 8;

__host__ __device__ __forceinline__ int lds_byte(int r, int c) { const int st = (r >> 4) * 2 + (c >> 5), rr = r & 15, cc = c & 31, ob = rr * 64 + cc * 2; return st * 1024 + (ob ^ (((ob >> 9) & 1) << 5)); }
__host__ __device__ __forceinline__ void stage_rc(int b, int& R, int& C) { const int st = b / 1024, sb = b % 1024, swz = sb ^ (((sb >> 9) & 1) << 5); R = (st >> 1) * 16 + swz / 64; C = (st & 1) * 32 + (swz % 64) / 2; }
__host__ __device__ __forceinline__ int perm32(int rho) { const int n = rho >> 4, i = rho & 15; return 8 * (i >> 2) + 4 * n + (i & 3); }

struct Unit { int pm, pn; };
struct Gemm { const bf16_t* A; const bf16_t* Bt; int M, N, K; };

struct StaticOrder {
    int nM, nN, nwg, G, c;
    __host__ __device__ void init(int M, int N, int G_, int c_) { nM = M / BM; nN = N / BM; nwg = nM * nN; G = G_; c = c_; }
    __host__ __device__ bool next(int i, Unit& u) const {
        const long L = (long)i * G + c; if (L >= nwg) return false;
        int wgid = (int)L; { const int q = nwg / NXCD, r = nwg % NXCD, xcd = wgid % NXCD, off = wgid / NXCD; wgid = (xcd < r ? xcd * (q + 1) : r * (q + 1) + (xcd - r) * q) + off; }
        const int nig = WGM * nN, gid = wgid / nig, fm = gid * WGM, gsz = (nM - fm) < WGM ? (nM - fm) : WGM;
        u.pm = fm + ((wgid % nig) % gsz); u.pn = (wgid % nig) / gsz; return true;
    }
    __device__ __forceinline__ void a_ready(const Unit&) const {}
    __device__ __forceinline__ void done(const Unit&) const {}
};


__device__ __forceinline__ unsigned cvt_pk_bf16(float lo, float hi) { unsigned r; asm volatile("v_cvt_pk_bf16_f32 %0, %1, %2" : "=v"(r) : "v"(lo), "v"(hi)); return r; }
__device__ __forceinline__ float gelu_tanh1(float x) {
    const float t = x * (1.0f + 0.044715f * x * x);
    const float e = __builtin_amdgcn_exp2f(t * (-2.302208198f));
    return x * __builtin_amdgcn_rcpf(1.0f + e);
}
template <int ACT  > struct EpiAct {
    static constexpr bool PERM = true, AFTER_DRAIN = false;
    bf16_t* O; int ldc; int gelu_tiles;
    __device__ __forceinline__ void operator()(const f32x4 (&acc)[2][2][4][2], const Unit& u, int wr, int wc, int fr, int fq) const {
        const int row0 = u.pm * BM + wr * 64 + fr; const int col0 = u.pn * BM + wc * 32 + 8 * fq;
        const bool do_gelu = (ACT == 1) && (u.pn < gelu_tiles);
#pragma unroll
        for (int ai = 0; ai < 2; ++ai)
#pragma unroll
            for (int m = 0; m < 4; ++m) { bf16_t* rowp = O + (size_t)(row0 + ai * HALF + m * 16) * ldc + col0;
#pragma unroll
                for (int bj = 0; bj < 2; ++bj) { f32x4 v0 = acc[ai][bj][m][0], v1 = acc[ai][bj][m][1];
                    if (ACT == 1) { if (do_gelu) {
#pragma unroll
                        for (int j = 0; j < 4; ++j) { v0[j] = gelu_tanh1(v0[j]); v1[j] = gelu_tanh1(v1[j]); } } }
                    if (ACT == 2) {
#pragma unroll
                        for (int j = 0; j < 4; ++j) { const float a = fmaxf(v0[j], 0.f), b = fmaxf(v1[j], 0.f); v0[j] = a * a; v1[j] = b * b; } }
                    u32x4 w; w.x = cvt_pk_bf16(v0[0], v0[1]); w.y = cvt_pk_bf16(v0[2], v0[3]); w.z = cvt_pk_bf16(v1[0], v1[1]); w.w = cvt_pk_bf16(v1[2], v1[3]);
                    *(u32x4*)(rowp + bj * HALF) = w; } }
    }
};

template <class Epi, class Sched, bool ALIGN_EPI = false, bool SP2 = false>
__device__ __forceinline__ void gemm_phase(PG8_LAS unsigned char* lds, const Gemm g, const Sched& S, const Epi& E) {
    const int tid = threadIdx.x, wid = __builtin_amdgcn_readfirstlane(tid >> 6), lane = tid & 63, wr = wid >> 2, wc = wid & 3, fr = lane & 15, fq = lane >> 4;
    const int K = g.K, nt = K / BK;
    unsigned voffA[2], voffB[2];
#pragma unroll
    for (int i = 0; i < 2; ++i) { int R, C; stage_rc(tid * 16 + i * 8192, R, C); const int Rb = Epi::PERM ? ((R & ~31) + perm32(R & 31)) : R;
        voffA[i] = (unsigned)(R * K + C) * 2u; voffB[i] = (unsigned)(Rb * K + C) * 2u; }
    const size_t kstep = (size_t)(BK * 2);
    const size_t hstep = (size_t)HALF * K * 2;
    const size_t tstep = 2 * hstep;
    const unsigned ldsw = (unsigned)wid * 1024u;
    const int aoff = lds_byte(wr * 64 + fr, fq * 8), boff = lds_byte(wc * 32 + fr, fq * 8);
#define PG8_SA(b, h) (((b) * 2 + (h)) * HTB)
#define PG8_SB(b, h) ((4 + (b) * 2 + (h)) * HTB)
#define PG8_STAGE(bufoff, gbase, voff) do { _Pragma("unroll") for (int _i = 0; _i < 2; ++_i) \
        __builtin_amdgcn_global_load_lds((const unsigned*)((const char*)(gbase) + (voff)[_i]), (PG8_LAS unsigned*)(lds + (bufoff) + ldsw + _i * 8192), 16, 0, 0); } while (0)
#define PG8_LDA(dst, b, h) do { _Pragma("unroll") for (int m = 0; m < 4; ++m) _Pragma("unroll") for (int k = 0; k < 2; ++k) dst[m][k] = *(const PG8_LAS bf16x8*)(lds + PG8_SA(b, h) + aoff + m * 2048 + k * 1024); } while (0)
#define PG8_LDB(dst, b, h) do { _Pragma("unroll") for (int n = 0; n < 2; ++n) _Pragma("unroll") for (int k = 0; k < 2; ++k) dst[n][k] = *(const PG8_LAS bf16x8*)(lds + PG8_SB(b, h) + boff + n * 2048 + k * 1024); } while (0)
#define PG8_MMA(ai, bj, At, Bt) do { __builtin_amdgcn_s_setprio(1); _Pragma("unroll") for (int m = 0; m < 4; ++m) _Pragma("unroll") for (int n = 0; n < 2; ++n) _Pragma("unroll") for (int k = 0; k < 2; ++k) \
        acc[ai][bj][m][n] = __builtin_amdgcn_mfma_f32_16x16x32_bf16(Bt[n][k], At[m][k], acc[ai][bj][m][n], 0, 0, 0); __builtin_amdgcn_s_setprio(0); } while (0)
#define PG8_WAIT_V(n) asm volatile("s_waitcnt vmcnt(" #n ")" ::: "memory")
#define PG8_WAIT_L(n) asm volatile("s_waitcnt lgkmcnt(" #n ")" ::: "memory")
#define PG8_BAR __builtin_amdgcn_s_barrier()
#define PG8_SCHED __builtin_amdgcn_sched_barrier(0)
    Unit cur, nxt; int ui = 0;
    if (!S.next(0, cur)) return;
    f32x4 acc[2][2][4][2];
#pragma unroll
    for (int a = 0; a < 2; ++a)
#pragma unroll
        for (int b = 0; b < 2; ++b)
#pragma unroll
            for (int m = 0; m < 4; ++m)
#pragma unroll
                for (int n = 0; n < 2; ++n) acc[a][b][m][n] = (f32x4){0.f, 0.f, 0.f, 0.f};
    bf16x8 At[4][2], B0[2][2], B1[2][2];
    const char* cA = (const char*)g.A + (size_t)cur.pm * tstep; const char* cB = (const char*)g.Bt + (size_t)cur.pn * tstep;
    S.a_ready(cur);
    if constexpr (SP2) {
        PG8_STAGE(PG8_SB(0, 0), cB, voffB); PG8_STAGE(PG8_SB(0, 1), cB + hstep, voffB); PG8_STAGE(PG8_SA(0, 0), cA, voffA); PG8_STAGE(PG8_SA(0, 1), cA + hstep, voffA);
        if (wr == 1) PG8_BAR;
        PG8_WAIT_V(2); PG8_BAR;
        PG8_STAGE(PG8_SB(1, 0), cB + kstep, voffB); PG8_STAGE(PG8_SA(1, 0), cA + kstep, voffA); PG8_STAGE(PG8_SB(1, 1), cB + hstep + kstep, voffB);
        PG8_WAIT_V(6); PG8_BAR;
    } else {
        PG8_STAGE(PG8_SB(0, 0), cB, voffB); PG8_STAGE(PG8_SA(0, 0), cA, voffA); PG8_STAGE(PG8_SB(0, 1), cB + hstep, voffB); PG8_STAGE(PG8_SA(0, 1), cA + hstep, voffA);
        if (wr == 1) PG8_BAR;
        PG8_WAIT_V(4); PG8_BAR;
        PG8_STAGE(PG8_SB(1, 0), cB + kstep, voffB); PG8_STAGE(PG8_SA(1, 0), cA + kstep, voffA); PG8_STAGE(PG8_SB(1, 1), cB + hstep + kstep, voffB);
        PG8_WAIT_V(6); PG8_BAR;
    }
    for (;;) {
        const bool has_next = S.next(ui + 1, nxt);
        const char* nA = has_next ? (const char*)g.A + (size_t)nxt.pm * tstep : cA; const char* nB = has_next ? (const char*)g.Bt + (size_t)nxt.pn * tstep : cB;
        for (int t = 0; t < nt; t += 2) {
            const bool last = (t == nt - 2);
            const char* a1 = cA + (size_t)(t + 1) * kstep;
            const char* a2 = last ? nA : cA + (size_t)(t + 2) * kstep; const char* b2 = last ? nB : cB + (size_t)(t + 2) * kstep;
            const char* a3 = a2 + kstep; const char* b3 = b2 + kstep;
            if (last && has_next) S.a_ready(nxt);
            if constexpr (SP2) {
            PG8_LDB(B0, 0, 0); PG8_LDB(B1, 0, 1); PG8_SCHED; PG8_LDA(At, 0, 0); PG8_STAGE(PG8_SA(1, 1), a1 + hstep, voffA);
            PG8_WAIT_V(8); PG8_WAIT_L(0); PG8_BAR; PG8_MMA(0, 0, At, B0); PG8_MMA(0, 1, At, B1); PG8_BAR; PG8_SCHED;
            PG8_LDA(At, 0, 1); PG8_STAGE(PG8_SB(0, 0), b2, voffB); PG8_STAGE(PG8_SB(0, 1), b2 + hstep, voffB); PG8_STAGE(PG8_SA(0, 0), a2, voffA);
            PG8_WAIT_V(8); PG8_WAIT_L(0); PG8_BAR; PG8_MMA(1, 0, At, B0); PG8_MMA(1, 1, At, B1); PG8_BAR; PG8_SCHED;
            PG8_LDB(B0, 1, 0); PG8_LDB(B1, 1, 1); PG8_SCHED; PG8_LDA(At, 1, 0); PG8_STAGE(PG8_SA(0, 1), a2 + hstep, voffA);
            PG8_WAIT_V(8); PG8_WAIT_L(0); PG8_BAR; PG8_MMA(0, 0, At, B0); PG8_MMA(0, 1, At, B1); PG8_BAR; PG8_SCHED;
            PG8_LDA(At, 1, 1); PG8_STAGE(PG8_SB(1, 0), b3, voffB); PG8_STAGE(PG8_SB(1, 1), b3 + hstep, voffB); PG8_STAGE(PG8_SA(1, 0), a3, voffA);
            PG8_WAIT_V(8); PG8_WAIT_L(0); PG8_BAR; PG8_MMA(1, 0, At, B0); PG8_MMA(1, 1, At, B1); PG8_BAR; PG8_SCHED;
            } else {
            PG8_LDB(B0, 0, 0); PG8_SCHED; PG8_LDA(At, 0, 0); PG8_STAGE(PG8_SA(1, 1), a1 + hstep, voffA);
            PG8_WAIT_L(8); PG8_BAR; PG8_WAIT_L(0); PG8_MMA(0, 0, At, B0); PG8_BAR; PG8_SCHED;
            PG8_LDB(B1, 0, 1); PG8_STAGE(PG8_SB(0, 0), b2, voffB);
            PG8_BAR; PG8_WAIT_L(0); PG8_MMA(0, 1, At, B1); PG8_BAR;
            PG8_LDA(At, 0, 1); PG8_STAGE(PG8_SA(0, 0), a2, voffA);
            PG8_BAR; PG8_WAIT_L(0); PG8_MMA(1, 0, At, B0); PG8_BAR; PG8_SCHED;
            PG8_STAGE(PG8_SB(0, 1), b2 + hstep, voffB);
            PG8_WAIT_V(6); PG8_BAR; PG8_MMA(1, 1, At, B1); PG8_BAR;
            PG8_LDB(B0, 1, 0); PG8_SCHED; PG8_LDA(At, 1, 0); PG8_STAGE(PG8_SA(0, 1), a2 + hstep, voffA);
            PG8_WAIT_L(8); PG8_BAR; PG8_WAIT_L(0); PG8_MMA(0, 0, At, B0); PG8_BAR; PG8_SCHED;
            PG8_LDB(B1, 1, 1); PG8_STAGE(PG8_SB(1, 0), b3, voffB);
            PG8_BAR; PG8_WAIT_L(0); PG8_MMA(0, 1, At, B1); PG8_BAR;
            PG8_LDA(At, 1, 1); PG8_STAGE(PG8_SA(1, 0), a3, voffA);
            PG8_BAR; PG8_WAIT_L(0); PG8_MMA(1, 0, At, B0); PG8_BAR; PG8_SCHED;
            PG8_STAGE(PG8_SB(1, 1), b3 + hstep, voffB);
            PG8_WAIT_V(6); PG8_BAR; PG8_MMA(1, 1, At, B1); PG8_BAR;
            }
        }
        if constexpr (ALIGN_EPI) { if (wr == 0) PG8_BAR; }
        if constexpr (!Epi::AFTER_DRAIN) { E(acc, cur, wr, wc, fr, fq); S.done(cur); }
        if (!has_next) break;
#pragma unroll
        for (int a = 0; a < 2; ++a)
#pragma unroll
            for (int b = 0; b < 2; ++b)
#pragma unroll
                for (int m = 0; m < 4; ++m)
#pragma unroll
                    for (int n = 0; n < 2; ++n) acc[a][b][m][n] = (f32x4){0.f, 0.f, 0.f, 0.f};
        cur = nxt; cA = nA; cB = nB; ++ui;
        if constexpr (ALIGN_EPI) { if (wr == 1) PG8_BAR; }
    }
    PG8_WAIT_V(0);
    if constexpr (!ALIGN_EPI) { if (wr == 0) PG8_BAR; }
    PG8_BAR;
    if constexpr (Epi::AFTER_DRAIN) { E.fused(acc, cur, wr, wc, fr, fq, lds, wid, lane); S.done(cur); }
#undef PG8_SA
#undef PG8_SB
#undef PG8_STAGE
#undef PG8_LDA
#undef PG8_LDB
#undef PG8_MMA
#undef PG8_WAIT_V
#undef PG8_WAIT_L
#undef PG8_BAR
#undef PG8_SCHED
}
}

#ifndef PG8_SP2
#define PG8_SP2 true
#endif
#ifndef PG8_ALIGN
#define PG8_ALIGN true
#endif
#ifndef MK_N_LAUNCHES
#define MK_N_LAUNCHES 9
#endif

constexpr int NWAVES = 8, NTHR = NWAVES * 64;
constexpr int BATCH = 8, SEQ = 4096, D = 1024, M = BATCH * SEQ, NZ = 1536, DA = 512, FF = 4096, CH = 128, NMOD = 6 * D;
constexpr float EPS = 1e-6f;
constexpr int NPHASES = 9;
constexpr size_t MiB = 1u << 20;
constexpr size_t WS_MOD = 0;
constexpr size_t WS_WSP = 1 * MiB;
constexpr size_t WS_WPT = 1 * MiB + 512 * 1024;
constexpr size_t WS_WIN = 2 * MiB;
constexpr size_t WS_WOUT = 5 * MiB;
constexpr size_t WS_W1 = 8 * MiB;
constexpr size_t WS_W2 = 16 * MiB;
constexpr size_t WS_H = 32 * MiB;
constexpr size_t WS_Z = 96 * MiB;
constexpr size_t WS_Y = 192 * MiB;
constexpr size_t WS_MIX = 256 * MiB;
constexpr size_t WS_A = 96 * MiB;
constexpr size_t WS_F = 352 * MiB;
constexpr size_t WS_END = 416 * MiB;
constexpr int LDS_BYTES = 147456;

#define LAS __attribute__((address_space(3)))
typedef unsigned short bf16;
typedef float f32x4 __attribute__((ext_vector_type(4)));
typedef unsigned u32x4 __attribute__((ext_vector_type(4)));
typedef unsigned u32x2 __attribute__((ext_vector_type(2)));
typedef short bf16x8 __attribute__((ext_vector_type(8)));
typedef short s16x4 __attribute__((ext_vector_type(4)));

struct Args { const float* in[19]; float* out; unsigned char* ws; int ph_lo, ph_hi; };

__device__ __forceinline__ unsigned f2bf(float f) { unsigned u = __builtin_bit_cast(unsigned, f); return (u + 0x7fffu + ((u >> 16) & 1u)) >> 16; }
__device__ __forceinline__ unsigned pk2(float lo, float hi) { return f2bf(lo) | (f2bf(hi) << 16); }
__device__ __forceinline__ float bflo(unsigned w) { return __builtin_bit_cast(float, w << 16); }
__device__ __forceinline__ float bfhi(unsigned w) { return __builtin_bit_cast(float, w & 0xffff0000u); }
__device__ __forceinline__ float wave_sum(float v) {
#pragma unroll
    for (int o = 1; o < 64; o <<= 1) v += __shfl_xor(v, o);
    return v;
}
#define LDS_WAIT() asm volatile("s_waitcnt lgkmcnt(0)" ::: "memory")

__device__ __forceinline__ void p0_transpose_item(const float* W, int K, int N, bf16* WT, LAS float* scr, int item, int lane) {
    const int nblk = N / 32, kb = item / nblk, nb = item % nblk, k0 = 64 * kb, n0 = 32 * nb;
#pragma unroll 8
    for (int i = 0; i < 32; ++i) { const int kk = 2 * i + (lane >> 5); scr[kk * 33 + (lane & 31)] = W[(size_t)(k0 + kk) * N + n0 + (lane & 31)]; }
    LDS_WAIT(); asm volatile("" ::: "memory");
    const int c = lane & 7;
#pragma unroll
    for (int j = 0; j < 4; ++j) { const int n = (lane >> 3) + 8 * j; const LAS float* s = scr + (8 * c) * 33 + n;
        u32x4 o; o.x = pk2(s[0 * 33], s[1 * 33]); o.y = pk2(s[2 * 33], s[3 * 33]); o.z = pk2(s[4 * 33], s[5 * 33]); o.w = pk2(s[6 * 33], s[7 * 33]);
        *(u32x4*)(WT + (size_t)(n0 + n) * K + k0 + 8 * c) = o; }
    LDS_WAIT(); asm volatile("" ::: "memory");
}

__device__ __forceinline__ void p0_prologue(const Args& a, LAS unsigned char* lds, int tid, int lane, int wave) {
    float* mod = (float*)(a.ws + WS_MOD);
    for (int cb = blockIdx.x; cb < NMOD / 64; cb += gridDim.x) {
        LAS float* sc = (LAS float*)lds;
        LAS float* part = (LAS float*)(lds + 32768);
        const float* c = a.in[1];
        for (int i = tid; i < BATCH * D; i += NTHR) { const float v = c[i]; sc[i] = v / (1.f + __expf(-v)); }
        __syncthreads();
        const int col0 = cb * 64, c4 = tid & 15, kg = tid >> 4;
        const float* W = a.in[2] + (size_t)(kg * 32) * NMOD + col0 + 4 * c4;
        f32x4 acc[8];
#pragma unroll
        for (int b = 0; b < 8; ++b) acc[b] = (f32x4){0.f, 0.f, 0.f, 0.f};
#pragma unroll 8
        for (int i = 0; i < 32; ++i) { const f32x4 w = *(const f32x4*)(W + (size_t)i * NMOD);
#pragma unroll
            for (int b = 0; b < 8; ++b) acc[b] += sc[b * D + kg * 32 + i] * w; }
#pragma unroll
        for (int b = 0; b < 8; ++b) *(LAS f32x4*)(part + (kg * 8 + b) * 64 + 4 * c4) = acc[b];
        __syncthreads();
        { const int b = tid >> 6, col = tid & 63; float s = a.in[3][col0 + col];
#pragma unroll 8
          for (int k2 = 0; k2 < 32; ++k2) s += part[(k2 * 8 + b) * 64 + col];
          mod[b * NMOD + col0 + col] = s; }
        __syncthreads();
    }
    { bf16* Wsp = (bf16*)(a.ws + WS_WSP); const float* ws = a.in[7];
      for (int i = blockIdx.x * NTHR + tid; i < 4 * CH * CH; i += gridDim.x * NTHR) { const int s = i & 127, t = (i >> 7) & 127; Wsp[i] = (bf16)f2bf(s <= t ? ws[i] : 0.f); } }
    LAS float* scr = (LAS float*)(lds + wave * 16384);
    const int gw = blockIdx.x * NWAVES + wave, NGW = gridDim.x * NWAVES;
    constexpr int I_IN = (D / 64) * (NZ / 32), I_OUT = (D / 64) * (D / 32), I_1 = (D / 64) * (FF / 32), I_2 = (FF / 64) * (D / 32), I_P = (128 / 64) * (128 / 32);
    constexpr int NITEMS = I_IN + I_OUT + I_1 + I_2 + 4 * I_P;
    for (int it = gw; it < NITEMS; it += NGW) {
        int r = it;
        if (r < I_IN) { p0_transpose_item(a.in[6], D, NZ, (bf16*)(a.ws + WS_WIN), scr, r, lane); continue; } r -= I_IN;
        if (r < I_OUT) { p0_transpose_item(a.in[14], D, D, (bf16*)(a.ws + WS_WOUT), scr, r, lane); continue; } r -= I_OUT;
        if (r < I_1) { p0_transpose_item(a.in[17], D, FF, (bf16*)(a.ws + WS_W1), scr, r, lane); continue; } r -= I_1;
        if (r < I_2) { p0_transpose_item(a.in[18], FF, D, (bf16*)(a.ws + WS_W2), scr, r, lane); continue; } r -= I_2;
        { const int g = r / I_P; p0_transpose_item(a.in[11] + (size_t)g * 128 * 128, 128, 128, (bf16*)(a.ws + WS_WPT) + (size_t)g * 128 * 128, scr, r % I_P, lane); }
    }
}

__device__ __forceinline__ void p1_rows(const Args& a, int lane, int wave) {
    const float* mod = (const float*)(a.ws + WS_MOD); bf16* H = (bf16*)(a.ws + WS_H); const float* x = a.in[0];
    const int gw = blockIdx.x * NWAVES + wave, NGW = gridDim.x * NWAVES;
    for (int rb = gw; rb < M / 16; rb += NGW) {
        const int r0 = rb * 16, b = r0 / SEQ;
        f32x4 gm[4], sh[4];
#pragma unroll
        for (int j = 0; j < 4; ++j) { const int c = 4 * lane + 256 * j;
            gm[j] = *(const f32x4*)(a.in[4] + c) * (*(const f32x4*)(mod + b * NMOD + 1 * D + c) + 1.0f); sh[j] = *(const f32x4*)(mod + b * NMOD + c); }
#pragma unroll 2
        for (int r = r0; r < r0 + 16; ++r) {
            f32x4 v[4]; float ss = 0.f;
#pragma unroll
            for (int j = 0; j < 4; ++j) { v[j] = *(const f32x4*)(x + (size_t)r * D + 4 * lane + 256 * j); ss += (v[j].x * v[j].x + v[j].y * v[j].y) + (v[j].z * v[j].z + v[j].w * v[j].w); }
            const float rinv = 1.0f / sqrtf(wave_sum(ss) * (1.f / D) + EPS);
#pragma unroll
            for (int j = 0; j < 4; ++j) { const f32x4 h = v[j] * rinv * gm[j] + sh[j];
                u32x2 o; o.x = pk2(h.x, h.y); o.y = pk2(h.z, h.w); *(u32x2*)(H + (size_t)r * D + 4 * lane + 256 * j) = o; }
        }
    }
}

constexpr int VP = 264;
__device__ __forceinline__ int vt_row(int d) { return (d & 7) * 68 + (d >> 3); }
template <int W> __device__ __forceinline__ bf16x8 pool_frag(const bf16* zb  , int pos) {
    float s[8], cur[8];
#pragma unroll
    for (int j = 0; j < 8; ++j) { s[j] = 0.f; cur[j] = 0.f; }
#pragma unroll
    for (int jj = 0; jj < W; ++jj) { const int pr = pos - jj; const float mk = pr >= 0 ? 1.f : 0.f; const int prc = pr >= 0 ? pr : 0;
        const u32x4 raw = *(const u32x4*)(zb + (size_t)prc * NZ);
        const float v[8] = {bflo(raw.x), bfhi(raw.x), bflo(raw.y), bfhi(raw.y), bflo(raw.z), bfhi(raw.z), bflo(raw.w), bfhi(raw.w)};
#pragma unroll
        for (int j = 0; j < 8; ++j) { if (jj == 0) cur[j] = v[j]; s[j] += mk * v[j]; } }
    const int cnt = (pos + 1) < W ? (pos + 1) : W; const float inv = 1.0f / (float)cnt;
    u32x4 o; o.x = pg8::cvt_pk_bf16(s[0] * inv - cur[0], s[1] * inv - cur[1]); o.y = pg8::cvt_pk_bf16(s[2] * inv - cur[2], s[3] * inv - cur[3]);
    o.z = pg8::cvt_pk_bf16(s[4] * inv - cur[4], s[5] * inv - cur[5]); o.w = pg8::cvt_pk_bf16(s[6] * inv - cur[6], s[7] * inv - cur[7]);
    return __builtin_bit_cast(bf16x8, o);
}
__device__ __forceinline__ void p3_mixer(const Args& a, LAS unsigned char* lds, int tid, int lane, int wave) {
    const bf16* Z = (const bf16*)(a.ws + WS_Z); bf16* Y = (bf16*)(a.ws + WS_Y);
    const bf16* Wsp = (const bf16*)(a.ws + WS_WSP); const bf16* WpT = (const bf16*)(a.ws + WS_WPT);
    const int fr = lane & 15, fq = lane >> 4;
    for (int ch = blockIdx.x; ch < M / CH; ch += gridDim.x) {
        const int t0 = ch * CH, p0 = t0 % SEQ; const size_t brow0 = (size_t)(t0 - p0);
        { float gain[8], bias[8];
#pragma unroll
          for (int j = 0; j < 8; ++j) { gain[j] = a.in[9][8 * lane + j]; bias[j] = a.in[10][8 * lane + j]; }
#pragma unroll 2
          for (int i = 0; i < 8; ++i) { const int s = 16 * wave + 2 * i; float y[2][8];
#pragma unroll
              for (int q = 0; q < 2; ++q) { const u32x4 raw = *(const u32x4*)(Z + (size_t)(t0 + s + q) * NZ + DA + 8 * lane);
                  float v[8] = {bflo(raw.x), bfhi(raw.x), bflo(raw.y), bfhi(raw.y), bflo(raw.z), bfhi(raw.z), bflo(raw.w), bfhi(raw.w)};
                  float sm = 0.f;
#pragma unroll
                  for (int j = 0; j < 8; ++j) sm += v[j];
                  const float mean = wave_sum(sm) * (1.f / DA); float sq = 0.f;
#pragma unroll
                  for (int j = 0; j < 8; ++j) { v[j] -= mean; sq += v[j] * v[j]; }
                  const float rstd = 1.0f / sqrtf(wave_sum(sq) * (1.f / DA) + EPS);
#pragma unroll
                  for (int j = 0; j < 8; ++j) y[q][j] = v[j] * rstd * gain[j] + bias[j]; }
#pragma unroll
              for (int j = 0; j < 8; ++j) *(LAS unsigned*)(lds + (j * 68 + lane) * VP + s * 2) = pg8::cvt_pk_bf16(y[0][j], y[1][j]); } }
        __syncthreads();
        { const int h = wave >> 1, th = wave & 1;
          bf16x8 af[4][4];
#pragma unroll
          for (int m = 0; m < 4; ++m)
#pragma unroll
              for (int k = 0; k < 4; ++k) af[m][k] = *(const bf16x8*)(Wsp + (size_t)((h * 128 + 64 * th + 16 * m + fr) * 128 + 32 * k + 8 * fq));
#pragma unroll 1
          for (int nh = 0; nh < 2; ++nh) {
              f32x4 acc[4][4];
#pragma unroll
              for (int m = 0; m < 4; ++m)
#pragma unroll
                  for (int n = 0; n < 4; ++n) acc[m][n] = (f32x4){0.f, 0.f, 0.f, 0.f};
#pragma unroll
              for (int n = 0; n < 4; ++n) { const int d = h * 128 + 16 * (4 * nh + n) + fr;
#pragma unroll
                  for (int k = 0; k < 4; ++k) { const LAS unsigned char* p = lds + vt_row(d) * VP + (32 * k + 8 * fq) * 2;
                      const s16x4 lo = *(const LAS s16x4*)p, hi = *(const LAS s16x4*)(p + 8);
                      const bf16x8 bv = __builtin_shufflevector(lo, hi, 0, 1, 2, 3, 4, 5, 6, 7);
#pragma unroll
                      for (int m = 0; m < 4; ++m) acc[m][n] = __builtin_amdgcn_mfma_f32_16x16x32_bf16(bv, af[m][k], acc[m][n], 0, 0, 0); } }
#pragma unroll
              for (int m = 0; m < 4; ++m) { const int t = 64 * th + 16 * m + fr; const float bsp = a.in[8][h * 128 + t];
#pragma unroll
                  for (int n = 0; n < 4; ++n) { const int dcol = h * 128 + 16 * (4 * nh + n) + 4 * fq;
                      const u32x2 ur = *(const u32x2*)(Z + (size_t)(t0 + t) * NZ + dcol);
                      const f32x4 c = acc[m][n];
                      u32x2 o; o.x = pg8::cvt_pk_bf16(bflo(ur.x) * (c[0] + bsp), bfhi(ur.x) * (c[1] + bsp)); o.y = pg8::cvt_pk_bf16(bflo(ur.y) * (c[2] + bsp), bfhi(ur.y) * (c[3] + bsp));
                      *(u32x2*)(Y + (size_t)(t0 + t) * D + dcol) = o; } }
          } }
        { const int g = wave >> 1, th = wave & 1;
          bf16x8 af[4][4];
#pragma unroll
          for (int m = 0; m < 4; ++m) { const int pos = p0 + 64 * th + 16 * m + fr;
#pragma unroll
              for (int k = 0; k < 4; ++k) { const bf16* zb = Z + brow0 * NZ + 2 * DA + g * 128 + 32 * k + 8 * fq;
                  if (g == 0) af[m][k] = pool_frag<2>(zb, pos); else if (g == 1) af[m][k] = pool_frag<4>(zb, pos); else if (g == 2) af[m][k] = pool_frag<8>(zb, pos); else af[m][k] = pool_frag<16>(zb, pos); } }
#pragma unroll 1
          for (int nh = 0; nh < 2; ++nh) {
              f32x4 acc[4][4];
#pragma unroll
              for (int m = 0; m < 4; ++m)
#pragma unroll
                  for (int n = 0; n < 4; ++n) acc[m][n] = (f32x4){0.f, 0.f, 0.f, 0.f};
#pragma unroll
              for (int n = 0; n < 4; ++n)
#pragma unroll
                  for (int k = 0; k < 4; ++k) { const bf16x8 bv = *(const bf16x8*)(WpT + (size_t)((g * 128 + 16 * (4 * nh + n) + fr) * 128 + 32 * k + 8 * fq));
#pragma unroll
                      for (int m = 0; m < 4; ++m) acc[m][n] = __builtin_amdgcn_mfma_f32_16x16x32_bf16(bv, af[m][k], acc[m][n], 0, 0, 0); }
#pragma unroll
              for (int m = 0; m < 4; ++m) { const int t = 64 * th + 16 * m + fr;
#pragma unroll
                  for (int n = 0; n < 4; ++n) { const int dd = g * 128 + 16 * (4 * nh + n) + 4 * fq;
                      const f32x4 bp = *(const f32x4*)(a.in[12] + dd), ps = *(const f32x4*)(a.in[13] + dd);
                      const f32x4 c = (acc[m][n] + bp) * ps;
                      u32x2 o; o.x = pg8::cvt_pk_bf16(c[0], c[1]); o.y = pg8::cvt_pk_bf16(c[2], c[3]);
                      *(u32x2*)(Y + (size_t)(t0 + t) * D + DA + dd) = o; } }
          } }
        __syncthreads();
    }
}

__device__ __forceinline__ void p5_rows(const Args& a, int lane, int wave) {
    const float* mod = (const float*)(a.ws + WS_MOD); bf16* H = (bf16*)(a.ws + WS_H); const bf16* MIX = (const bf16*)(a.ws + WS_MIX); const float* x = a.in[0]; float* out = a.out;
    const int gw = blockIdx.x * NWAVES + wave, NGW = gridDim.x * NWAVES;
    for (int rb = gw; rb < M / 16; rb += NGW) {
        const int r0 = rb * 16, b = r0 / SEQ;
        f32x4 g1[4], gm[4], sh[4];
#pragma unroll
        for (int j = 0; j < 4; ++j) { const int c = 4 * lane + 256 * j;
            g1[j] = *(const f32x4*)(mod + b * NMOD + 2 * D + c) * *(const f32x4*)(a.in[5] + c);
            gm[j] = *(const f32x4*)(a.in[15] + c) * (*(const f32x4*)(mod + b * NMOD + 4 * D + c) + 1.0f); sh[j] = *(const f32x4*)(mod + b * NMOD + 3 * D + c); }
#pragma unroll 2
        for (int r = r0; r < r0 + 16; ++r) {
            f32x4 v[4], mv[4]; float ss = 0.f;
#pragma unroll
            for (int j = 0; j < 4; ++j) { v[j] = *(const f32x4*)(x + (size_t)r * D + 4 * lane + 256 * j);
                const u32x2 mr = *(const u32x2*)(MIX + (size_t)r * D + 4 * lane + 256 * j); mv[j] = (f32x4){bflo(mr.x), bfhi(mr.x), bflo(mr.y), bfhi(mr.y)};
                ss += (mv[j].x * mv[j].x + mv[j].y * mv[j].y) + (mv[j].z * mv[j].z + mv[j].w * mv[j].w); }
            const float rinv = 1.0f / sqrtf(wave_sum(ss) * (1.f / D) + EPS); float s2 = 0.f;
#pragma unroll
            for (int j = 0; j < 4; ++j) { v[j] = v[j] + g1[j] * (mv[j] * rinv); *(f32x4*)(out + (size_t)r * D + 4 * lane + 256 * j) = v[j];
                s2 += (v[j].x * v[j].x + v[j].y * v[j].y) + (v[j].z * v[j].z + v[j].w * v[j].w); }
            const float rinv2 = 1.0f / sqrtf(wave_sum(s2) * (1.f / D) + EPS);
#pragma unroll
            for (int j = 0; j < 4; ++j) { const f32x4 h = v[j] * rinv2 * gm[j] + sh[j];
                u32x2 o; o.x = pk2(h.x, h.y); o.y = pk2(h.z, h.w); *(u32x2*)(H + (size_t)r * D + 4 * lane + 256 * j) = o; }
        }
    }
}
__device__ __forceinline__ void p8_rows(const Args& a, int lane, int wave) {
    const float* mod = (const float*)(a.ws + WS_MOD); const bf16* F = (const bf16*)(a.ws + WS_F); float* out = a.out;
    const int gw = blockIdx.x * NWAVES + wave, NGW = gridDim.x * NWAVES;
    for (int rb = gw; rb < M / 16; rb += NGW) {
        const int r0 = rb * 16, b = r0 / SEQ;
        f32x4 g2[4];
#pragma unroll
        for (int j = 0; j < 4; ++j) { const int c = 4 * lane + 256 * j; g2[j] = *(const f32x4*)(mod + b * NMOD + 5 * D + c) * *(const f32x4*)(a.in[16] + c); }
#pragma unroll 2
        for (int r = r0; r < r0 + 16; ++r) {
            f32x4 v[4], fv[4]; float ss = 0.f;
#pragma unroll
            for (int j = 0; j < 4; ++j) { v[j] = *(const f32x4*)(out + (size_t)r * D + 4 * lane + 256 * j);
                const u32x2 fr2 = *(const u32x2*)(F + (size_t)r * D + 4 * lane + 256 * j); fv[j] = (f32x4){bflo(fr2.x), bfhi(fr2.x), bflo(fr2.y), bfhi(fr2.y)};
                ss += (fv[j].x * fv[j].x + fv[j].y * fv[j].y) + (fv[j].z * fv[j].z + fv[j].w * fv[j].w); }
            const float rinv = 1.0f / sqrtf(wave_sum(ss) * (1.f / D) + EPS);
#pragma unroll
            for (int j = 0; j < 4; ++j) *(f32x4*)(out + (size_t)r * D + 4 * lane + 256 * j) = v[j] + g2[j] * (fv[j] * rinv);
        }
    }
}

__global__ void __launch_bounds__(NTHR, 2) fwd(Args a) {
    extern __shared__ __attribute__((aligned(16))) unsigned char lds_raw[];
    LAS unsigned char* lds = (LAS unsigned char*)lds_raw;
    const int tid = threadIdx.x, lane = tid & 63, wave = __builtin_amdgcn_readfirstlane(tid >> 6);
    const int lo = a.ph_lo, hi = a.ph_hi;
#define IN(k) (lo <= (k) && (k) < hi)
#if MK_N_LAUNCHES == 1
#define SEAM(k) do { if (IN(k) && IN((k) + 1)) cg::this_grid().sync(); } while (0)
#else
#define SEAM(k) do { } while (0)
#endif
    bf16* H = (bf16*)(a.ws + WS_H); bf16* Zb = (bf16*)(a.ws + WS_Z); bf16* Yb = (bf16*)(a.ws + WS_Y); bf16* MIXb = (bf16*)(a.ws + WS_MIX); bf16* Ab = (bf16*)(a.ws + WS_A); bf16* Fb = (bf16*)(a.ws + WS_F);
    if (IN(0)) { p0_prologue(a, lds, tid, lane, wave); } SEAM(0);
    if (IN(1)) { p1_rows(a, lane, wave); } SEAM(1);
    if (IN(2)) {
        pg8::Gemm g{H, (const bf16*)(a.ws + WS_WIN), M, NZ, D}; pg8::StaticOrder S; S.init(M, NZ, (int)gridDim.x, (int)blockIdx.x);
        pg8::EpiAct<1> E{Zb, NZ, 4};
        pg8::gemm_phase<pg8::EpiAct<1>, pg8::StaticOrder, PG8_ALIGN, PG8_SP2>(lds, g, S, E);
    } SEAM(2);
    if (IN(3)) { p3_mixer(a, lds, tid, lane, wave); } SEAM(3);
    if (IN(4)) {
        pg8::Gemm g{Yb, (const bf16*)(a.ws + WS_WOUT), M, D, D}; pg8::StaticOrder S; S.init(M, D, (int)gridDim.x, (int)blockIdx.x);
        pg8::EpiAct<0> E{MIXb, D, 0};
        pg8::gemm_phase<pg8::EpiAct<0>, pg8::StaticOrder, PG8_ALIGN, PG8_SP2>(lds, g, S, E);
    } SEAM(4);
    if (IN(5)) { p5_rows(a, lane, wave); } SEAM(5);
    if (IN(6)) {
        pg8::Gemm g{H, (const bf16*)(a.ws + WS_W1), M, FF, D}; pg8::StaticOrder S; S.init(M, FF, (int)gridDim.x, (int)blockIdx.x);
        pg8::EpiAct<2> E{Ab, FF, 0};
        pg8::gemm_phase<pg8::EpiAct<2>, pg8::StaticOrder, PG8_ALIGN, PG8_SP2>(lds, g, S, E);
    } SEAM(6);
    if (IN(7)) {
        pg8::Gemm g{Ab, (const bf16*)(a.ws + WS_W2), M, D, FF}; pg8::StaticOrder S; S.init(M, D, (int)gridDim.x, (int)blockIdx.x);
        pg8::EpiAct<0> E{Fb, D, 0};
        pg8::gemm_phase<pg8::EpiAct<0>, pg8::StaticOrder, PG8_ALIGN, PG8_SP2>(lds, g, S, E);
    } SEAM(7);
    if (IN(8)) { p8_rows(a, lane, wave); }
#undef IN
#undef SEAM
}

extern "C" void kernel_launch(void* const* d_in, const int* in_sizes, int n_in, void* d_out, int out_size, void* d_ws, size_t ws_size, hipStream_t stream) {
    static int grid = 0;
    if (grid == 0) {
        if (n_in != 19 || in_sizes[0] != M * D || out_size != M * D || ws_size < WS_END) { fprintf(stderr, "kernel_launch: unexpected shapes (n_in %d, in0 %d, out %d, ws %zu); nothing launched\n", n_in, n_in > 0 ? in_sizes[0] : -1, out_size, ws_size); grid = -1; return; }
        int dev = 0, cus = 0, per_cu = 0;
        if (hipGetDevice(&dev) != hipSuccess || hipDeviceGetAttribute(&cus, hipDeviceAttributeMultiprocessorCount, dev) != hipSuccess) { grid = -1; return; }
        if (hipFuncSetAttribute((const void*)fwd, hipFuncAttributeMaxDynamicSharedMemorySize, LDS_BYTES) != hipSuccess) { fprintf(stderr, "kernel_launch: hipFuncSetAttribute failed\n"); grid = -1; return; }
        if (hipOccupancyMaxActiveBlocksPerMultiprocessor(&per_cu, (const void*)fwd, NTHR, LDS_BYTES) != hipSuccess || per_cu < 1) { fprintf(stderr, "kernel_launch: occupancy query reports %d\n", per_cu); per_cu = 1; }
        (void)hipGetLastError();
        grid = cus * (per_cu > 1 ? 1 : per_cu);
    }
    if (grid < 0) return;
    Args a{};
    for (int i = 0; i < 19; ++i) a.in[i] = (const float*)d_in[i];
    a.out = (float*)d_out; a.ws = (unsigned char*)d_ws;
#if MK_N_LAUNCHES == 1
    a.ph_lo = 0; a.ph_hi = NPHASES;
    void* args[] = {&a};
    hipError_t e = hipLaunchCooperativeKernel((const void*)fwd, dim3(grid), dim3(NTHR), args, LDS_BYTES, stream);
    if (e != hipSuccess) fprintf(stderr, "kernel_launch: cooperative launch failed: %s (grid %d)\n", hipGetErrorString(e), grid);
#else
    for (int p = 0; p < NPHASES; ++p) { a.ph_lo = p; a.ph_hi = p + 1; hipLaunchKernelGGL(fwd, dim3(grid), dim3(NTHR), LDS_BYTES, stream, a); }
#endif
}
```
